# Optimizing an MI355X kernel written in HIP

```python
import math
import jax, jax.numpy as jnp
from jax import lax
import numpy as np

D_MODEL = 1024
BATCH = 2
SEQ = 8192
DEPTH = 2

HEAD_DIM = 64
ROPE_THETA = 500000.0
NORM_EPS = 1e-6
Q_BLOCK = 128
A_HEADS = 4
A_Q_DIM = A_HEADS * 2 * HEAD_DIM
A_K_DIM = A_HEADS * 2 * HEAD_DIM
A_V_DIM = A_HEADS * 2 * HEAD_DIM
B_HEADS = 8
B_Q_DIM = B_HEADS * HEAD_DIM
B_KV_DIM = HEAD_DIM
IDX_HEADS = 4
IDX_DIM = 32
IDX_Q_DIM = IDX_HEADS * IDX_DIM
IDX_TOPK_MAX = 256
C_HEADS = 8
C_DIM = C_HEADS * HEAD_DIM
MOBA_BLOCK = 256
MOBA_TOPK = 3
MOBA_Q_CHUNK = 64
N_BRANCH = 3
BRANCH_WIDTH = 512
GATE_DIM = N_BRANCH * D_MODEL
IN_SPLIT = (A_Q_DIM, A_K_DIM, A_V_DIM,
            B_Q_DIM, B_KV_DIM, B_KV_DIM, IDX_Q_DIM, IDX_DIM, IDX_HEADS,
            C_DIM, C_DIM, C_DIM,
            GATE_DIM)
D_IN = (A_Q_DIM + A_K_DIM + A_V_DIM + B_Q_DIM + 2 * B_KV_DIM + IDX_Q_DIM + IDX_DIM
        + IDX_HEADS + 3 * C_DIM + GATE_DIM)
D_FF = -(-8 * D_MODEL // (3 * 256)) * 256

kernel_name = "hybrid_diff_dsa_moba_gated_block"


def rms_norm(x, g):
    xf = x.astype(jnp.float32)
    y = xf * lax.rsqrt(jnp.mean(xf * xf, axis=-1, keepdims=True) + NORM_EPS)
    return (y * g.astype(jnp.float32)).astype(x.dtype)


def partial_rope(x, positions):
    rot = x.shape[-1] // 4
    half = rot // 2
    inv = jnp.power(ROPE_THETA, -jnp.arange(half, dtype=jnp.float32) * 2.0 / rot)
    ang = positions.astype(jnp.float32)[:, :, None] * inv
    cos = jnp.cos(ang)[:, :, None, :].astype(x.dtype)
    sin = jnp.sin(ang)[:, :, None, :].astype(x.dtype)
    x1, x2, rest = x[..., :half], x[..., half:rot], x[..., rot:]
    return jnp.concatenate([x1 * cos - x2 * sin, x2 * cos + x1 * sin, rest], axis=-1)


def diff_attention(q, k, v, lam, subln_g, lam_init):
    B, S, H, _, d = q.shape
    nq = S // Q_BLOCK
    qb = q.reshape(B, nq, Q_BLOCK, H, 2, d).swapaxes(0, 1)
    kpos = jnp.arange(S)
    scale = d ** -0.5

    def one_block(args):
        i, qi = args
        qpos = i * Q_BLOCK + jnp.arange(Q_BLOCK)
        logits = jnp.einsum('bqhcd,bkhcd->bhcqk', qi, k,
                            preferred_element_type=jnp.float32) * scale
        causal = kpos[None, :] <= qpos[:, None]
        logits = jnp.where(causal, logits, -jnp.inf)
        p = jax.nn.softmax(logits, axis=-1)
        attn = p[:, :, 0] - lam * p[:, :, 1]
        return jnp.einsum('bhqk,bkhe->bqhe', attn.astype(v.dtype), v)

    out = lax.map(one_block, (jnp.arange(nq), qb))
    out = out.swapaxes(0, 1).reshape(B, S, H, 2 * d)
    out = rms_norm(out, subln_g) * (1.0 - lam_init)
    return out.reshape(B, S, H * 2 * d)


def dsa_attention(q, k, v, iq, ik, iw, topk):
    B, S, H, d = q.shape
    nq = S // Q_BLOCK
    kpos = jnp.arange(S)
    scale = d ** -0.5
    gather = jax.vmap(lambda t, i: t[i])
    qb = q.reshape(B, nq, Q_BLOCK, H, d).swapaxes(0, 1)
    iqb = iq.reshape(B, nq, Q_BLOCK, IDX_HEADS, IDX_DIM).swapaxes(0, 1)
    iwb = iw.reshape(B, nq, Q_BLOCK, IDX_HEADS).swapaxes(0, 1)

    def one_block(args):
        i, qi, iqi, iwi = args
        qpos = i * Q_BLOCK + jnp.arange(Q_BLOCK)
        rel = jax.nn.relu(jnp.einsum('bqhe,bke->bqhk', iqi, ik,
                                     preferred_element_type=jnp.float32))
        score = jnp.einsum('bqh,bqhk->bqk', iwi.astype(jnp.float32), rel)
        score = jnp.where((kpos[None, :] <= qpos[:, None])[None], score, -jnp.inf)
        _, idx = lax.top_k(score, topk)
        valid = idx <= qpos[None, :, None]
        k_sel = gather(k, idx)
        v_sel = gather(v, idx)
        logits = jnp.einsum('bqhd,bqkd->bhqk', qi, k_sel,
                            preferred_element_type=jnp.float32) * scale
        logits = jnp.where(valid[:, None], logits, -jnp.inf)
        p = jax.nn.softmax(logits, axis=-1)
        return jnp.einsum('bhqk,bqkd->bqhd', p.astype(v.dtype), v_sel)

    out = lax.map(one_block, (jnp.arange(nq), qb, iqb, iwb))
    return out.swapaxes(0, 1).reshape(B, S, H * d)


def moba_attention(q, k, v):
    B, S, H, d = q.shape
    nb = -(-S // MOBA_BLOCK)
    pad = nb * MOBA_BLOCK - S

    def to_blocks(t):
        t = jnp.pad(t, ((0, 0), (0, pad), (0, 0), (0, 0)))
        return t.reshape(B, nb, MOBA_BLOCK, H, d).transpose(0, 3, 1, 2, 4)

    kb, vb = to_blocks(k), to_blocks(v)
    kmean = jnp.mean(kb.astype(jnp.float32), axis=3)
    ntop = min(MOBA_TOPK, nb - 1)
    nc = S // MOBA_Q_CHUNK
    qc_all = q.reshape(B, nc, MOBA_Q_CHUNK, H, d).swapaxes(0, 1)
    scale = d ** -0.5
    blk_ids = jnp.arange(nb)
    gather = jax.vmap(jax.vmap(lambda t, i: t[i]))

    def one_chunk(args):
        c, qc = args
        qpos = c * MOBA_Q_CHUNK + jnp.arange(MOBA_Q_CHUNK)
        own = (c * MOBA_Q_CHUNK) // MOBA_BLOCK
        k_own = lax.dynamic_index_in_dim(kb, own, axis=2, keepdims=False)
        v_own = lax.dynamic_index_in_dim(vb, own, axis=2, keepdims=False)
        kpos_own = own * MOBA_BLOCK + jnp.arange(MOBA_BLOCK)
        lo = jnp.einsum('bqhd,bhkd->bhqk', qc, k_own,
                        preferred_element_type=jnp.float32) * scale
        lo = jnp.where(kpos_own[None, :] <= qpos[:, None], lo, -jnp.inf)
        if ntop == 0:
            p = jax.nn.softmax(lo, axis=-1)
            return jnp.einsum('bhqk,bhkd->bqhd', p.astype(v.dtype), v_own)
        gate = jnp.einsum('bqhd,bhnd->bhqn', qc.astype(jnp.float32), kmean)
        gate = jnp.where(blk_ids < own, gate, -jnp.inf)
        _, idx = lax.top_k(gate, ntop)
        valid = idx < own
        k_sel = gather(kb, idx)
        v_sel = gather(vb, idx)
        lp = jnp.einsum('bqhd,bhqnkd->bhqnk', qc, k_sel,
                        preferred_element_type=jnp.float32) * scale
        lp = jnp.where(valid[..., None], lp, -jnp.inf)
        lp = lp.reshape(B, H, MOBA_Q_CHUNK, ntop * MOBA_BLOCK)
        p = jax.nn.softmax(jnp.concatenate([lo, lp], axis=-1), axis=-1)
        po = p[..., :MOBA_BLOCK].astype(v.dtype)
        pp = p[..., MOBA_BLOCK:].reshape(B, H, MOBA_Q_CHUNK, ntop, MOBA_BLOCK).astype(v.dtype)
        return (jnp.einsum('bhqk,bhkd->bqhd', po, v_own)
                + jnp.einsum('bhqnk,bhqnkd->bqhd', pp, v_sel))

    out = lax.map(one_chunk, (jnp.arange(nc), qc_all))
    return out.swapaxes(0, 1).reshape(B, S, H * d)


def hybrid_mixer(h, positions, w_in, w_branch, w_out, lq1, lk1, lq2, lk2, subln_g, lam_init):
    B, S, _ = h.shape
    proj = jnp.einsum('bsd,de->bse', h, w_in)
    offsets = [int(o) for o in np.cumsum(IN_SPLIT)[:-1]]
    (a_q, a_k, a_v, b_q, b_k, b_v, i_q, i_k, i_w,
     c_q, c_k, c_v, gates) = jnp.split(proj, offsets, axis=-1)

    a_q = partial_rope(a_q.reshape(B, S, 2 * A_HEADS, HEAD_DIM), positions)
    a_k = partial_rope(a_k.reshape(B, S, 2 * A_HEADS, HEAD_DIM), positions)
    a_q = a_q.reshape(B, S, A_HEADS, 2, HEAD_DIM)
    a_k = a_k.reshape(B, S, A_HEADS, 2, HEAD_DIM)
    a_v = a_v.reshape(B, S, A_HEADS, 2 * HEAD_DIM)
    lam = (jnp.exp(jnp.sum(lq1.astype(jnp.float32) * lk1.astype(jnp.float32)))
           - jnp.exp(jnp.sum(lq2.astype(jnp.float32) * lk2.astype(jnp.float32)))
           + lam_init)
    y_a = diff_attention(a_q, a_k, a_v, lam, subln_g, lam_init)

    topk = min(IDX_TOPK_MAX, S // 4)
    b_q = partial_rope(b_q.reshape(B, S, B_HEADS, HEAD_DIM), positions)
    b_k = partial_rope(b_k.reshape(B, S, 1, HEAD_DIM), positions)[:, :, 0]
    i_q = partial_rope(i_q.reshape(B, S, IDX_HEADS, IDX_DIM), positions)
    i_k = partial_rope(i_k.reshape(B, S, 1, IDX_DIM), positions)[:, :, 0]
    y_b = dsa_attention(b_q, b_k, b_v, i_q, i_k, i_w, topk)

    c_q = partial_rope(c_q.reshape(B, S, C_HEADS, HEAD_DIM), positions)
    c_k = partial_rope(c_k.reshape(B, S, C_HEADS, HEAD_DIM), positions)
    c_v = c_v.reshape(B, S, C_HEADS, HEAD_DIM)
    y_c = moba_attention(c_q, c_k, c_v)

    g = jax.nn.sigmoid(gates.reshape(B, S, N_BRANCH, D_MODEL))
    ys = jnp.stack([y_a, y_b, y_c], axis=2)
    branches = jnp.einsum('bsnw,nwd->bsnd', ys, w_branch)
    merged = jnp.sum(g * branches, axis=2)
    return jnp.einsum('bsd,de->bse', merged, w_out)


def swiglu(h, w_ffn_in, w_ffn_out):
    gu = jnp.einsum('bsd,df->bsf', h, w_ffn_in)
    gt, up = jnp.split(gu, 2, axis=-1)
    return jnp.einsum('bsf,fd->bsd', jax.nn.silu(gt) * up, w_ffn_out)


def setup_inputs(seed: int = 0) -> dict:
    key = jax.random.key(seed)
    ks = jax.random.split(key, 14)
    f32 = jnp.float32
    x = jax.random.normal(ks[0], (BATCH, SEQ, D_MODEL), f32)
    offset = jax.random.randint(ks[1], (BATCH, 1), 0, 1024, dtype=jnp.int32)
    positions = (offset + jnp.arange(SEQ, dtype=jnp.int32)[None, :]).astype(jnp.int32)
    w_in = jax.random.normal(ks[2], (DEPTH, D_MODEL, D_IN), f32) * D_MODEL ** -0.5
    w_branch = jax.random.normal(ks[3], (DEPTH, N_BRANCH, BRANCH_WIDTH, D_MODEL), f32) * BRANCH_WIDTH ** -0.5
    w_out = jax.random.normal(ks[4], (DEPTH, D_MODEL, D_MODEL), f32) * D_MODEL ** -0.5
    lambda_q1 = jax.random.normal(ks[5], (DEPTH, HEAD_DIM), f32) * 0.1
    lambda_k1 = jax.random.normal(ks[6], (DEPTH, HEAD_DIM), f32) * 0.1
    lambda_q2 = jax.random.normal(ks[7], (DEPTH, HEAD_DIM), f32) * 0.1
    lambda_k2 = jax.random.normal(ks[8], (DEPTH, HEAD_DIM), f32) * 0.1
    subln_g = 1.0 + 0.02 * jax.random.normal(ks[9], (DEPTH, 2 * HEAD_DIM), f32)
    norm_g = 1.0 + 0.02 * jax.random.normal(ks[10], (DEPTH, 4, D_MODEL), f32)
    w_ffn_in = jax.random.normal(ks[11], (DEPTH, D_MODEL, 2 * D_FF), f32) * D_MODEL ** -0.5
    w_ffn_out = jax.random.normal(ks[12], (DEPTH, D_FF, D_MODEL), f32) * D_FF ** -0.5
    return {"x": x, "positions": positions, "w_in": w_in, "w_branch": w_branch,
            "w_out": w_out, "lambda_q1": lambda_q1, "lambda_k1": lambda_k1,
            "lambda_q2": lambda_q2, "lambda_k2": lambda_k2, "subln_g": subln_g,
            "norm_g": norm_g, "w_ffn_in": w_ffn_in, "w_ffn_out": w_ffn_out}


def reference(x, positions, w_in, w_branch, w_out, lambda_q1, lambda_k1, lambda_q2,
              lambda_k2, subln_g, norm_g, w_ffn_in, w_ffn_out):
    for l in range(DEPTH):
        lam_init = 0.8 - 0.6 * math.exp(-0.3 * l)
        h = rms_norm(x, norm_g[l, 0])
        m = hybrid_mixer(h, positions, w_in[l], w_branch[l], w_out[l], lambda_q1[l],
                         lambda_k1[l], lambda_q2[l], lambda_k2[l], subln_g[l], lam_init)
        x = x + rms_norm(m, norm_g[l, 1])
        h = rms_norm(x, norm_g[l, 2])
        x = x + rms_norm(swiglu(h, w_ffn_in[l], w_ffn_out[l]), norm_g[l, 3])
    return x
```

```cpp
#include <hip/hip_runtime.h>
#include <cstdint>
#include <cstdio>

typedef _Float16 h16;
typedef unsigned short u16;

constexpr int BATCH = 2, SEQ = 8192, DM = 1024, DEPTH = 2, M = BATCH * SEQ;
constexpr int D_IN = 6948, D_FF = 2816;
constexpr int NIN = 4096;
constexpr int NG = 3072;
constexpr float NORM_EPS = 1e-6f;
constexpr float C2 = 0.125f * 1.4426950408889634f;
constexpr int N_AQ = 0, N_AK = 512, N_AV = 1024, N_BQ = 1536, N_CQ = 2048, N_CK = 2560, N_CV = 3072, N_BK = 3584, N_BV = 3648, N_IQ = 3712, N_IK = 3840, N_IW = 3872;

constexpr size_t MiB = 1u << 20;
constexpr size_t WS_CTL = 0;
constexpr size_t WS_CS64 = 1 * MiB;
constexpr size_t WS_CS32 = 2 * MiB;
constexpr size_t WS_WIN = 3 * MiB;
constexpr size_t WS_WG = 11 * MiB;
constexpr size_t WS_WBR = 17 * MiB;
constexpr size_t WS_WOUT = 20 * MiB;
constexpr size_t WS_WFI = 22 * MiB;
constexpr size_t WS_WFO = 33 * MiB;
constexpr size_t WS_XN = 39 * MiB;
constexpr size_t WS_R = 71 * MiB;
constexpr size_t WS_AQ = WS_R + 0 * MiB, WS_AK = WS_R + 16 * MiB, WS_AV = WS_R + 32 * MiB, WS_BQ = WS_R + 48 * MiB, WS_CQ = WS_R + 64 * MiB, WS_CK = WS_R + 80 * MiB, WS_CV = WS_R + 96 * MiB;
constexpr size_t WS_BK = WS_R + 112 * MiB, WS_BV = WS_R + 114 * MiB, WS_IQ = WS_R + 116 * MiB, WS_IK = WS_R + 120 * MiB, WS_IW = WS_R + 121 * MiB;
constexpr size_t WS_IDX = 193 * MiB;
constexpr size_t WS_YS = 208 * MiB;
constexpr size_t WS_G = WS_R;
constexpr size_t WS_T = 167 * MiB;
constexpr size_t WS_MERGED = 167 * MiB;
constexpr size_t WS_MF = WS_R;
constexpr size_t WS_F = 136 * MiB;
constexpr size_t WS_END = 256 * MiB;

__device__ __forceinline__ float wave_sum(float v) {
#pragma unroll
    for (int o = 1; o < 64; o <<= 1) v += __shfl_xor(v, o);
    return v;
}

__global__ void k_tables(const int* __restrict__ pos, float* __restrict__ cs64, float* __restrict__ cs32) {
    const int m = blockIdx.x * blockDim.x + threadIdx.x;
    if (m >= M) return;
    const float p = (float)pos[m];
#pragma unroll
    for (int j = 0; j < 8; ++j) {
        const float inv = powf(500000.0f, (-(float)j * 2.0f) / 16.0f);
        const float a = p * inv;
        cs64[m * 16 + j] = cosf(a); cs64[m * 16 + 8 + j] = sinf(a);
    }
#pragma unroll
    for (int j = 0; j < 4; ++j) {
        const float inv = powf(500000.0f, (-(float)j * 2.0f) / 8.0f);
        const float a = p * inv;
        cs32[m * 8 + j] = cosf(a); cs32[m * 8 + 4 + j] = sinf(a);
    }
}

__device__ __forceinline__ int map_col(int mode, int n) {
    if (mode == 0) {
        if (n < 2048) return n;
        if (n < 3584) return 2340 + (n - 2048);
        if (n < 3648) return 2048 + (n - 3584);
        if (n < 3712) return 2112 + (n - 3648);
        if (n < 3840) return 2176 + (n - 3712);
        if (n < 3872) return 2304 + (n - 3840);
        if (n < 3876) return 2336 + (n - 3872);
        return -1;
    }
    if (mode == 1) return 3876 + n;
    if (mode == 2) { const int g8 = n >> 3, w = n & 7; return (w < 4) ? (g8 * 4 + w) : (D_FF + g8 * 4 + (w - 4)); }
    return n;
}
__global__ void k_convw(const float* __restrict__ src, int ldsrc, int K, h16* __restrict__ dst, int N, int mode, const float* __restrict__ rowscale) {
    __shared__ float t[32][33];
    const int n0 = blockIdx.x * 32, k0 = blockIdx.y * 32, tx = threadIdx.x & 31, ty = threadIdx.x >> 5;
    const int c = map_col(mode, n0 + tx);
    for (int i = ty; i < 32; i += 8) { const int k = k0 + i; float v = (c >= 0) ? src[(size_t)k * ldsrc + c] : 0.f; if (rowscale) v *= rowscale[k]; t[i][tx] = v; }
    __syncthreads();
    for (int i = ty; i < 32; i += 8) dst[(size_t)(n0 + i) * K + k0 + tx] = (h16)t[tx][i];
}

__global__ void k_rmsnorm(const float* __restrict__ x, const float* __restrict__ g, h16* __restrict__ xn) {
    const int row = blockIdx.x * 4 + (threadIdx.x >> 6), lane = threadIdx.x & 63;
    const float* xr = x + (size_t)row * DM; float v[16]; float s = 0.f;
#pragma unroll
    for (int j = 0; j < 16; ++j) { v[j] = xr[lane + 64 * j]; s += v[j] * v[j]; }
    const float rstd = 1.0f / sqrtf(wave_sum(s) * (1.0f / DM) + NORM_EPS);
#pragma unroll
    for (int j = 0; j < 16; ++j) xn[(size_t)row * DM + lane + 64 * j] = (h16)(v[j] * rstd * g[lane + 64 * j]);
}
__global__ void k_norm_res(const float* __restrict__ mf, const float* xin, float* xout, const float* __restrict__ g1, const float* __restrict__ g2, h16* __restrict__ xn) {
    const int row = blockIdx.x * 4 + (threadIdx.x >> 6), lane = threadIdx.x & 63;
    const float* mr = mf + (size_t)row * DM; float v[16]; float s = 0.f;
#pragma unroll
    for (int j = 0; j < 16; ++j) { v[j] = mr[lane + 64 * j]; s += v[j] * v[j]; }
    const float rstd = 1.0f / sqrtf(wave_sum(s) * (1.0f / DM) + NORM_EPS);
    float s2 = 0.f;
#pragma unroll
    for (int j = 0; j < 16; ++j) { v[j] = xin[(size_t)row * DM + lane + 64 * j] + v[j] * rstd * g1[lane + 64 * j]; s2 += v[j] * v[j]; xout[(size_t)row * DM + lane + 64 * j] = v[j]; }
    if (xn) { const float r2 = 1.0f / sqrtf(wave_sum(s2) * (1.0f / DM) + NORM_EPS);
#pragma unroll
        for (int j = 0; j < 16; ++j) xn[(size_t)row * DM + lane + 64 * j] = (h16)(v[j] * r2 * g2[lane + 64 * j]); }
}

struct EpiArgs { unsigned char* ws; const float* cs64; const float* cs32; int n; int pad; };
enum { E_INPROJ = 0, E_GATES = 1, E_BRANCH = 2, E_RAW = 3, E_FFI = 4 };

__device__ __forceinline__ void rope_tile(float (*C)[65], int r, int o, int half, const float* cs) {
    for (int j = 0; j < half; ++j) { const float x1 = C[r][o + j], x2 = C[r][o + half + j], c = cs[j], s = cs[half + j]; C[r][o + j] = x1 * c - x2 * s; C[r][o + half + j] = x2 * c + x1 * s; }
}
template <int EPI>
__global__ void __launch_bounds__(256) k_gemm(const h16* __restrict__ A, int lda, const h16* __restrict__ Bt, int ldb, int K, EpiArgs ea) {
    __shared__ float As[64][33], Bs[64][33], C[64][65];
    const int m0 = blockIdx.y * 64, n0 = blockIdx.x * 64, tid = threadIdx.x, tx = tid & 15, ty = tid >> 4;
    float acc[4][4] = {};
    for (int k0 = 0; k0 < K; k0 += 32) {
        for (int e = tid; e < 64 * 32; e += 256) { const int r = e >> 5, c = e & 31; As[r][c] = (float)A[(size_t)(m0 + r) * lda + k0 + c]; Bs[r][c] = (float)Bt[(size_t)(n0 + r) * ldb + k0 + c]; }
        __syncthreads();
#pragma unroll 8
        for (int k = 0; k < 32; ++k) { float a[4], b[4];
#pragma unroll
            for (int i = 0; i < 4; ++i) { a[i] = As[ty + 16 * i][k]; b[i] = Bs[tx + 16 * i][k]; }
#pragma unroll
            for (int i = 0; i < 4; ++i)
#pragma unroll
                for (int j = 0; j < 4; ++j) acc[i][j] += a[i] * b[j]; }
        __syncthreads();
    }
#pragma unroll
    for (int i = 0; i < 4; ++i)
#pragma unroll
        for (int j = 0; j < 4; ++j) C[ty + 16 * i][tx + 16 * j] = acc[i][j];
    __syncthreads();
    unsigned char* ws = ea.ws;
    if (EPI == E_INPROJ) {
        int kind, dstcol; h16* dst; int dld; float sc = 1.f;
        if (n0 < N_AK) { kind = 1; dst = (h16*)(ws + WS_AQ); dld = 512; dstcol = n0 - N_AQ; sc = C2; }
        else if (n0 < N_AV) { kind = 1; dst = (h16*)(ws + WS_AK); dld = 512; dstcol = n0 - N_AK; }
        else if (n0 < N_BQ) { kind = 0; dst = (h16*)(ws + WS_AV); dld = 512; dstcol = n0 - N_AV; }
        else if (n0 < N_CQ) { kind = 1; dst = (h16*)(ws + WS_BQ); dld = 512; dstcol = n0 - N_BQ; sc = C2; }
        else if (n0 < N_CK) { kind = 1; dst = (h16*)(ws + WS_CQ); dld = 512; dstcol = n0 - N_CQ; sc = C2; }
        else if (n0 < N_CV) { kind = 1; dst = (h16*)(ws + WS_CK); dld = 512; dstcol = n0 - N_CK; }
        else if (n0 < N_BK) { kind = 0; dst = (h16*)(ws + WS_CV); dld = 512; dstcol = n0 - N_CV; }
        else if (n0 < N_BV) { kind = 1; dst = (h16*)(ws + WS_BK); dld = 64; dstcol = 0; }
        else if (n0 < N_IQ) { kind = 0; dst = (h16*)(ws + WS_BV); dld = 64; dstcol = 0; }
        else if (n0 < N_IK) { kind = 2; dst = (h16*)(ws + WS_IQ); dld = 128; dstcol = n0 - N_IQ; }
        else { kind = 3; dst = (h16*)(ws + WS_IK); dld = 32; dstcol = 0; }
        if (tid < 64) { const int r = tid, m = m0 + r;
            if (kind == 1) rope_tile(C, r, 0, 8, ea.cs64 + (size_t)m * 16);
            if (kind == 2) { rope_tile(C, r, 0, 4, ea.cs32 + (size_t)m * 8); rope_tile(C, r, 32, 4, ea.cs32 + (size_t)m * 8); }
            if (kind == 3) { rope_tile(C, r, 0, 4, ea.cs32 + (size_t)m * 8); float* iw = (float*)(ws + WS_IW) + (size_t)m * 4; for (int j = 0; j < 4; ++j) iw[j] = C[r][32 + j]; } }
        __syncthreads();
        const int ncol = (kind == 3) ? 32 : 64;
        for (int e = tid; e < 64 * ncol; e += 256) { const int r = e / ncol, c = e % ncol; dst[(size_t)(m0 + r) * dld + dstcol + c] = (h16)(C[r][c] * sc); }
    } else if (EPI == E_GATES) {
        h16* G = (h16*)(ws + WS_G);
        for (int e = tid; e < 4096; e += 256) { const int r = e >> 6, c = e & 63; G[(size_t)(m0 + r) * NG + n0 + c] = (h16)(1.0f / (1.0f + __expf(-C[r][c]))); }
    } else if (EPI == E_BRANCH) {
        const h16* G = (const h16*)(ws + WS_G); float* T = (float*)(ws + WS_MF + 0); h16* MG = (h16*)(ws + WS_MERGED);
        (void)T;
        for (int e = tid; e < 4096; e += 256) { const int r = e >> 6, c = e & 63; const size_t o = (size_t)(m0 + r) * DM + n0 + c;
            float v = (float)G[(size_t)(m0 + r) * NG + ea.n * DM + n0 + c] * C[r][c];
            if (ea.n > 0) v += (float)MG[o];
            MG[o] = (h16)v; }
    } else if (EPI == E_RAW) {
        float* MF = (float*)(ws + WS_MF);
        for (int e = tid; e < 4096; e += 256) { const int r = e >> 6, c = e & 63; MF[(size_t)(m0 + r) * DM + n0 + c] = C[r][c]; }
    } else if (EPI == E_FFI) {
        h16* F = (h16*)(ws + WS_F);
        for (int e = tid; e < 64 * 32; e += 256) { const int r = e >> 5, c = e & 31; const int g8 = c >> 2, w = c & 3; const float gt = C[r][g8 * 8 + w], up = C[r][g8 * 8 + 4 + w];
            F[(size_t)(m0 + r) * D_FF + (n0 >> 1) + c] = (h16)(gt / (1.0f + __expf(-gt)) * up); }
    }
}

__global__ void __launch_bounds__(256) k_attn_a(const unsigned char* ws_c, unsigned char* ws, const float* __restrict__ lq1, const float* __restrict__ lk1, const float* __restrict__ lq2, const float* __restrict__ lk2,
                                                const float* __restrict__ subg, float lam_init) {
    __shared__ float Ks[32][64], Vs[32][128];
    const int qb = (int)gridDim.x - 1 - (int)blockIdx.x, h = blockIdx.y, b = blockIdx.z, tid = threadIdx.x;
    const int q = qb * 256 + tid; const size_t m = (size_t)b * SEQ + q;
    const h16* AQ = (const h16*)(ws_c + WS_AQ); const h16* AK = (const h16*)(ws_c + WS_AK); const h16* AV = (const h16*)(ws_c + WS_AV); h16* YS = (h16*)(ws + WS_YS);
    float d1 = 0.f, d2 = 0.f;
    for (int i = 0; i < 64; ++i) { d1 += lq1[i] * lk1[i]; d2 += lq2[i] * lk2[i]; }
    const float lam = expf(d1) - expf(d2) + lam_init;
    float o[128]; float o0save_unused = 0.f; (void)o0save_unused;
    for (int c = 0; c < 2; ++c) {
        float qv[64];
#pragma unroll
        for (int i = 0; i < 64; ++i) qv[i] = (float)AQ[m * 512 + (h * 2 + c) * 64 + i];
#pragma unroll
        for (int i = 0; i < 128; ++i) o[i] = 0.f;
        float mx = -INFINITY, l = 0.f;
        const int kend = qb * 256 + 256;
        for (int t0 = 0; t0 < kend; t0 += 32) {
            __syncthreads();
            for (int e = tid; e < 32 * 64; e += 256) { const int r = e >> 6, cc = e & 63; Ks[r][cc] = (float)AK[((size_t)b * SEQ + t0 + r) * 512 + (h * 2 + c) * 64 + cc]; }
            for (int e = tid; e < 32 * 128; e += 256) { const int r = e >> 7, cc = e & 127; Vs[r][cc] = (float)AV[((size_t)b * SEQ + t0 + r) * 512 + h * 128 + cc]; }
            __syncthreads();
            for (int j = 0; j < 32; ++j) {
                if (t0 + j > q) break;
                float s = 0.f;
#pragma unroll
                for (int i = 0; i < 64; ++i) s += qv[i] * Ks[j][i];
                if (s > mx) { const float f = exp2f(mx - s); l *= f;
#pragma unroll
                    for (int i = 0; i < 128; ++i) o[i] *= f;
                    mx = s; }
                const float p = exp2f(s - mx); l += p;
#pragma unroll
                for (int i = 0; i < 128; ++i) o[i] += p * Vs[j][i];
            }
        }
        const float rl = 1.0f / l;
        if (c == 0) {
#pragma unroll
            for (int i = 0; i < 128; ++i) YS[m * 1536 + h * 128 + i] = (h16)(o[i] * rl);
        } else {
            float ss = 0.f;
#pragma unroll
            for (int i = 0; i < 128; ++i) { o[i] = (float)YS[m * 1536 + h * 128 + i] - lam * o[i] * rl; ss += o[i] * o[i]; }
            const float rs = 1.0f / sqrtf(ss * (1.0f / 128.0f) + NORM_EPS) * (1.0f - lam_init);
#pragma unroll
            for (int i = 0; i < 128; ++i) YS[m * 1536 + h * 128 + i] = (h16)(o[i] * rs * subg[i]);
        }
    }
}

__global__ void __launch_bounds__(256) k_attn_c(unsigned char* ws) {
    __shared__ float Ks[32][64], Vs[32][64], KM[32][64], part[4][64];
    const int j = (int)gridDim.x - 1 - (int)blockIdx.x, h = blockIdx.y, b = blockIdx.z, tid = threadIdx.x;
    const int q = j * 256 + tid; const size_t m = (size_t)b * SEQ + q;
    const h16* CQ = (const h16*)(ws + WS_CQ); const h16* CK = (const h16*)(ws + WS_CK); const h16* CV = (const h16*)(ws + WS_CV); h16* YS = (h16*)(ws + WS_YS);
    for (int n = 0; n < j; ++n) {
        const int d = tid & 63, p = tid >> 6; float s = 0.f;
        for (int i = 0; i < 64; ++i) s += (float)CK[((size_t)b * SEQ + n * 256 + p * 64 + i) * 512 + h * 64 + d];
        part[p][d] = s; __syncthreads();
        if (tid < 64) KM[n][tid] = (part[0][tid] + part[1][tid] + part[2][tid] + part[3][tid]) * (1.0f / 256.0f);
        __syncthreads();
    }
    float qv[64];
#pragma unroll
    for (int i = 0; i < 64; ++i) qv[i] = (float)CQ[m * 512 + h * 64 + i];
    unsigned sel = 0u;
    { float v1 = -INFINITY, v2 = -INFINITY, v3 = -INFINITY; int i1 = -1, i2 = -1, i3 = -1;
        for (int n = 0; n < j; ++n) { float s = 0.f;
#pragma unroll
            for (int i = 0; i < 64; ++i) s += qv[i] * KM[n][i];
            if (s > v1) { v3 = v2; i3 = i2; v2 = v1; i2 = i1; v1 = s; i1 = n; }
            else if (s > v2) { v3 = v2; i3 = i2; v2 = s; i2 = n; }
            else if (s > v3) { v3 = s; i3 = n; } }
        if (i1 >= 0) sel |= 1u << i1; if (i2 >= 0) sel |= 1u << i2; if (i3 >= 0) sel |= 1u << i3; }
    sel |= 1u << j;
    float o[64];
#pragma unroll
    for (int i = 0; i < 64; ++i) o[i] = 0.f;
    float mx = -INFINITY, l = 0.f;
    for (int t0 = 0; t0 < j * 256 + 256; t0 += 32) {
        __syncthreads();
        for (int e = tid; e < 32 * 64; e += 256) { const int r = e >> 6, cc = e & 63; const size_t src = ((size_t)b * SEQ + t0 + r) * 512 + h * 64 + cc; Ks[r][cc] = (float)CK[src]; Vs[r][cc] = (float)CV[src]; }
        __syncthreads();
        if (!((sel >> (t0 >> 8)) & 1u)) continue;
        for (int jj = 0; jj < 32; ++jj) {
            if (t0 + jj > q) break;
            float s = 0.f;
#pragma unroll
            for (int i = 0; i < 64; ++i) s += qv[i] * Ks[jj][i];
            if (s > mx) { const float f = exp2f(mx - s); l *= f;
#pragma unroll
                for (int i = 0; i < 64; ++i) o[i] *= f;
                mx = s; }
            const float p = exp2f(s - mx); l += p;
#pragma unroll
            for (int i = 0; i < 64; ++i) o[i] += p * Vs[jj][i];
        }
    }
    const float rl = 1.0f / l;
#pragma unroll
    for (int i = 0; i < 64; ++i) YS[m * 1536 + 1024 + h * 64 + i] = (h16)(o[i] * rl);
}

__device__ __forceinline__ unsigned fkey(float s) { s += 0.0f; const unsigned u = __float_as_uint(s); return (u & 0x80000000u) ? ~u : (u | 0x80000000u); }
__global__ void __launch_bounds__(256) k_attn_b(unsigned char* ws) {
    __shared__ unsigned key[SEQ]; __shared__ unsigned hist[256]; __shared__ unsigned short list[256]; __shared__ float iqs[128]; __shared__ float iws[4];
    __shared__ unsigned sh_prefix, sh_remaining, sh_cnt; __shared__ int cnts[256]; __shared__ float lg[8][256]; __shared__ float bq[512];
    const int q = SEQ - 1 - (int)blockIdx.x, b = blockIdx.y, tid = threadIdx.x; const size_t m = (size_t)b * SEQ + q;
    const h16* IQ = (const h16*)(ws + WS_IQ); const h16* IK = (const h16*)(ws + WS_IK); const float* IW = (const float*)(ws + WS_IW);
    const h16* BQ = (const h16*)(ws + WS_BQ); const h16* BK = (const h16*)(ws + WS_BK); const h16* BV = (const h16*)(ws + WS_BV); h16* YS = (h16*)(ws + WS_YS); u16* IDX = (u16*)(ws + WS_IDX);
    if (tid < 128) iqs[tid] = (float)IQ[m * 128 + tid];
    if (tid < 4) iws[tid] = IW[m * 4 + tid];
    for (int e = tid; e < 512; e += 256) bq[e] = (float)BQ[m * 512 + e];
    __syncthreads();
    const int n = q + 1; int count;
    if (n <= 256) { if (tid < n) list[tid] = (unsigned short)tid; count = n; }
    else {
        for (int k = tid; k < n; k += 256) { const h16* kr = IK + ((size_t)b * SEQ + k) * 32; float kk[32];
#pragma unroll
            for (int i = 0; i < 32; ++i) kk[i] = (float)kr[i];
            float s = 0.f;
#pragma unroll
            for (int hh = 0; hh < 4; ++hh) { float d = 0.f;
#pragma unroll
                for (int i = 0; i < 32; ++i) d += iqs[hh * 32 + i] * kk[i];
                s += iws[hh] * fmaxf(d, 0.f); }
            key[k] = fkey(s); }
        if (tid == 0) { sh_prefix = 0u; sh_remaining = 256u; }
        __syncthreads();
        for (int pass = 0; pass < 4; ++pass) {
            const int shift = 24 - 8 * pass; hist[tid] = 0u; __syncthreads();
            const unsigned pref = sh_prefix; const unsigned himask = (pass == 0) ? 0u : (0xFFFFFFFFu << (shift + 8));
            for (int k = tid; k < n; k += 256) { const unsigned kv = key[k]; if ((kv & himask) == pref) atomicAdd(&hist[(kv >> shift) & 255u], 1u); }
            __syncthreads();
            if (tid == 0) { unsigned rem = sh_remaining; int bin = 255; for (; bin > 0; --bin) { if (hist[bin] >= rem) break; rem -= hist[bin]; } sh_prefix = pref | ((unsigned)bin << shift); sh_remaining = rem; }
            __syncthreads();
        }
        const unsigned T = sh_prefix; const unsigned need_eq = sh_remaining;
        if (tid == 0) sh_cnt = 0u;
        int ce = 0; for (int k = tid * 32; k < tid * 32 + 32 && k < n; ++k) ce += (key[k] == T);
        cnts[tid] = ce; __syncthreads();
        if (tid == 0) { int run = 0; for (int i = 0; i < 256; ++i) { const int c = cnts[i]; cnts[i] = run; run += c; } }
        __syncthreads();
        int rank = cnts[tid];
        for (int k = tid * 32; k < tid * 32 + 32 && k < n; ++k) { const unsigned kv = key[k]; bool take = kv > T; if (kv == T) { take = (unsigned)rank < need_eq; ++rank; } if (take) { const unsigned p = atomicAdd(&sh_cnt, 1u); if (p < 256u) list[p] = (unsigned short)k; } }
        count = 256;
    }
    __syncthreads();
    if (tid < 256) IDX[m * 256 + tid] = (tid < count) ? list[tid] : (unsigned short)0;
    const int hd = tid >> 5, l32 = tid & 31;
    float mxl = -INFINITY;
    for (int i = l32; i < count; i += 32) { const h16* kr = BK + ((size_t)b * SEQ + list[i]) * 64; float s = 0.f;
#pragma unroll
        for (int d = 0; d < 64; ++d) s += bq[hd * 64 + d] * (float)kr[d];
        lg[hd][i] = s; mxl = fmaxf(mxl, s); }
#pragma unroll
    for (int o = 1; o < 32; o <<= 1) mxl = fmaxf(mxl, __shfl_xor(mxl, o));
    float sum = 0.f;
    for (int i = l32; i < count; i += 32) { const float p = exp2f(lg[hd][i] - mxl); lg[hd][i] = p; sum += p; }
#pragma unroll
    for (int o = 1; o < 32; o <<= 1) sum += __shfl_xor(sum, o);
    __syncthreads();
    float o0 = 0.f, o1 = 0.f;
    for (int i = 0; i < count; ++i) { const h16* vr = BV + ((size_t)b * SEQ + list[i]) * 64; const float p = lg[hd][i]; o0 += p * (float)vr[l32]; o1 += p * (float)vr[32 + l32]; }
    const float rl = 1.0f / sum;
    YS[m * 1536 + 512 + hd * 64 + l32] = (h16)(o0 * rl); YS[m * 1536 + 512 + hd * 64 + 32 + l32] = (h16)(o1 * rl);
}

extern "C" void kernel_launch(void* const* d_in, const int* in_sizes, int n_in, void* d_out, int out_size, void* d_ws, size_t ws_size, hipStream_t stream) {
    if (ws_size < WS_END) { fprintf(stderr, "workspace too small: %zu\n", ws_size); return; }
    const float* x = (const float*)d_in[0]; const int* pos = (const int*)d_in[1];
    const float* w_in = (const float*)d_in[2]; const float* w_branch = (const float*)d_in[3]; const float* w_out = (const float*)d_in[4];
    const float* lq1 = (const float*)d_in[5]; const float* lk1 = (const float*)d_in[6]; const float* lq2 = (const float*)d_in[7]; const float* lk2 = (const float*)d_in[8];
    const float* subg = (const float*)d_in[9]; const float* norm_g = (const float*)d_in[10]; const float* w_ffn_in = (const float*)d_in[11]; const float* w_ffn_out = (const float*)d_in[12];
    float* out = (float*)d_out; unsigned char* ws = (unsigned char*)d_ws;
    float* cs64 = (float*)(ws + WS_CS64); float* cs32 = (float*)(ws + WS_CS32);
    h16* XN = (h16*)(ws + WS_XN);
    k_tables<<<M / 256, 256, 0, stream>>>(pos, cs64, cs32);
    for (int l = 0; l < DEPTH; ++l) {
        const float lam_init = 0.8f - 0.6f * expf(-0.3f * (float)l);
        const float* wi = w_in + (size_t)l * DM * D_IN; const float* wb = w_branch + (size_t)l * 3 * 512 * DM; const float* wo = w_out + (size_t)l * DM * DM;
        const float* wfi = w_ffn_in + (size_t)l * DM * 2 * D_FF; const float* wfo = w_ffn_out + (size_t)l * D_FF * DM; const float* ng = norm_g + (size_t)l * 4 * DM;
        k_convw<<<dim3(NIN / 32, DM / 32), 256, 0, stream>>>(wi, D_IN, DM, (h16*)(ws + WS_WIN), NIN, 0, nullptr);
        k_convw<<<dim3(NG / 32, DM / 32), 256, 0, stream>>>(wi, D_IN, DM, (h16*)(ws + WS_WG), NG, 1, nullptr);
        for (int nb = 0; nb < 3; ++nb) k_convw<<<dim3(DM / 32, 512 / 32), 256, 0, stream>>>(wb + (size_t)nb * 512 * DM, DM, 512, (h16*)(ws + WS_WBR) + (size_t)nb * DM * 512, DM, 3, nullptr);
        k_convw<<<dim3(DM / 32, DM / 32), 256, 0, stream>>>(wo, DM, DM, (h16*)(ws + WS_WOUT), DM, 3, nullptr);
        k_convw<<<dim3(2 * D_FF / 32, DM / 32), 256, 0, stream>>>(wfi, 2 * D_FF, DM, (h16*)(ws + WS_WFI), 2 * D_FF, 2, nullptr);
        k_convw<<<dim3(DM / 32, D_FF / 32), 256, 0, stream>>>(wfo, DM, D_FF, (h16*)(ws + WS_WFO), DM, 3, nullptr);
        const float* xin = (l == 0) ? x : out;
        if (l == 0) k_rmsnorm<<<M / 4, 256, 0, stream>>>(xin, ng, XN);
        EpiArgs ea{ws, cs64, cs32, 0, 0};
        k_gemm<E_INPROJ><<<dim3(NIN / 64 - 3, M / 64), 256, 0, stream>>>(XN, DM, (const h16*)(ws + WS_WIN), DM, DM, ea);
        k_attn_a<<<dim3(SEQ / 256, 4, BATCH), 256, 0, stream>>>(ws, ws, lq1 + l * 64, lk1 + l * 64, lq2 + l * 64, lk2 + l * 64, subg + l * 128, lam_init);
        k_attn_b<<<dim3(SEQ, BATCH), 256, 0, stream>>>(ws);
        k_attn_c<<<dim3(SEQ / 256, 8, BATCH), 256, 0, stream>>>(ws);
        k_gemm<E_GATES><<<dim3(NG / 64, M / 64), 256, 0, stream>>>(XN, DM, (const h16*)(ws + WS_WG), DM, DM, ea);
        for (int nb = 0; nb < 3; ++nb) { ea.n = nb; k_gemm<E_BRANCH><<<dim3(DM / 64, M / 64), 256, 0, stream>>>((const h16*)(ws + WS_YS) + nb * 512, 1536, (const h16*)(ws + WS_WBR) + (size_t)nb * DM * 512, 512, 512, ea); }
        k_gemm<E_RAW><<<dim3(DM / 64, M / 64), 256, 0, stream>>>((const h16*)(ws + WS_MERGED), DM, (const h16*)(ws + WS_WOUT), DM, DM, ea);
        k_norm_res<<<M / 4, 256, 0, stream>>>((const float*)(ws + WS_MF), xin, out, ng + DM, ng + 2 * DM, XN);
        k_gemm<E_FFI><<<dim3(2 * D_FF / 64, M / 64), 256, 0, stream>>>(XN, DM, (const h16*)(ws + WS_WFI), DM, DM, ea);
        k_gemm<E_RAW><<<dim3(DM / 64, M / 64), 256, 0, stream>>>((const h16*)(ws + WS_F), D_FF, (const h16*)(ws + WS_WFO), D_FF, D_FF, ea);
        const float* ngn = (l + 1 < DEPTH) ? norm_g + (size_t)(l + 1) * 4 * DM : nullptr;
        k_norm_res<<<M / 4, 256, 0, stream>>>((const float*)(ws + WS_MF), out, out, ng + 3 * DM, ngn, (l + 1 < DEPTH) ? XN : nullptr);
    }
}
```
